# Optimizing an MI355X kernel written in HIP

```python
import math
import jax, jax.numpy as jnp
from jax import lax
import numpy as np


D_MODEL = 2048
BATCH = 1
SEQ = 16384
DEPTH = 4

N_EVEN = (DEPTH + 1) // 2
N_ODD = DEPTH // 2
D_FF = 4 * D_MODEL
HEAD_DIM = 128
ROT_DIM = HEAD_DIM // 4
ROPE_THETA = 500000.0
D_RNN = D_MODEL // 2
RNN_BLOCKS = 16
RNN_BLOCK_W = D_RNN // RNN_BLOCKS
CONV_W = 4
RG_C = 8.0
H_DIL = (D_MODEL - D_RNN) // HEAD_DIM
D_DIL = H_DIL * HEAD_DIM
DIL_PATTERNS = ((128, 1), (512, 4), (2048, 16))
H_DIFF = D_MODEL // (2 * HEAD_DIM)
D_DIFF = H_DIFF * 2 * HEAD_DIM
EVEN_IN = 2 * D_RNN + 3 * D_DIL
ODD_IN = 3 * D_DIFF
BLK = 128
ALPHA = (2 * DEPTH) ** 0.25
BETA = (8 * DEPTH) ** -0.25
LN_EPS = 1e-5
RMS_EPS = 1e-5
NEG = -1e30

kernel_name = 'hybrid_rglru_dilated_diffattn_trunk'


def layer_norm(x, g, b):
    xf = x.astype(jnp.float32)
    mu = jnp.mean(xf, axis=-1, keepdims=True)
    var = jnp.mean(jnp.square(xf - mu), axis=-1, keepdims=True)
    y = (xf - mu) * lax.rsqrt(var + LN_EPS) * g.astype(jnp.float32) + b.astype(jnp.float32)
    return y.astype(x.dtype)


def rope_tables(positions):
    inv = ROPE_THETA ** (-jnp.arange(0, ROT_DIM, 2, dtype=jnp.float32) / ROT_DIM)
    ang = positions.astype(jnp.float32)[..., None] * inv
    return jnp.cos(ang), jnp.sin(ang)


def apply_rope(x, cos, sin):
    shape = cos.shape[:2] + (1,) * (x.ndim - 3) + (cos.shape[-1],)
    c, s = cos.reshape(shape), sin.reshape(shape)
    half = ROT_DIM // 2
    xr = x[..., :ROT_DIM].astype(jnp.float32)
    x1, x2 = xr[..., :half], xr[..., half:]
    rot = jnp.concatenate([x1 * c - x2 * s, x2 * c + x1 * s], axis=-1).astype(x.dtype)
    return jnp.concatenate([rot, x[..., ROT_DIM:]], axis=-1)


def causal_depthwise_conv(x, w, b):
    y = lax.conv_general_dilated(x, w[:, None, :], window_strides=(1,), padding=[(CONV_W - 1, 0)],
                                 dimension_numbers=('NWC', 'WIO', 'NWC'), feature_group_count=x.shape[-1])
    return y + b


def rg_lru(xc, ga_w, ga_b, gx_w, gx_b, lam):
    B, S, C = xc.shape
    xb = xc.reshape(B, S, RNN_BLOCKS, RNN_BLOCK_W)
    r = jax.nn.sigmoid(jnp.einsum('bsnc,ncd->bsnd', xb, ga_w).reshape(B, S, C) + ga_b)
    i = jax.nn.sigmoid(jnp.einsum('bsnc,ncd->bsnd', xb, gx_w).reshape(B, S, C) + gx_b)
    log_a = (-RG_C * r.astype(jnp.float32)) * jax.nn.softplus(-lam.astype(jnp.float32))
    a = jnp.exp(log_a)
    u = jnp.sqrt(-jnp.expm1(2.0 * log_a)) * (i * xc).astype(jnp.float32)

    def combine(c1, c2):
        a1, b1 = c1
        a2, b2 = c2
        return a1 * a2, a2 * b1 + b2

    _, h = lax.associative_scan(combine, (a, u), axis=1)
    return h.astype(xc.dtype)


def to_strided(t, d):
    B, S = t.shape[:2]
    rest = t.shape[2:]
    return jnp.swapaxes(t.reshape((B, S // d, d) + rest), 1, 2).reshape((B * d, S // d) + rest)


def from_strided(t, d, B):
    L = t.shape[1]
    rest = t.shape[2:]
    return jnp.swapaxes(t.reshape((B, d, L) + rest), 1, 2).reshape((B, L * d) + rest)


def banded_window_attention(q, k, v, win_keys):
    N, L, H, D = q.shape
    nb = -(-L // BLK)
    Lp = nb * BLK
    qb = jnp.pad(q, ((0, 0), (0, Lp - L), (0, 0), (0, 0))).reshape(N, nb, BLK, H, D)

    def kv_blocks(t):
        tp = jnp.pad(t, ((0, 0), (BLK, Lp - L), (0, 0), (0, 0))).reshape(N, nb + 1, BLK, H, D)
        return jnp.concatenate([tp[:, :-1], tp[:, 1:]], axis=2)

    kb, vb = kv_blocks(k), kv_blocks(v)
    s = jnp.einsum('nbqhd,nbkhd->nbhqk', qb, kb).astype(jnp.float32) * (D ** -0.5)
    qi = jnp.arange(BLK)[:, None]
    kj = jnp.arange(2 * BLK)[None, :]
    dist = qi + BLK - kj
    kpos = jnp.arange(nb)[:, None, None] * BLK - BLK + kj[None]
    valid = (dist >= 0) & (dist <= win_keys) & (kpos >= 0)
    s = jnp.where(valid[None, :, None], s, NEG)
    lse = jax.nn.logsumexp(s, axis=-1)
    p = jnp.exp(s - lse[..., None])
    o = jnp.einsum('nbhqk,nbkhd->nbqhd', p.astype(v.dtype), vb).reshape(N, Lp, H, D)[:, :L]
    lse = jnp.transpose(lse, (0, 1, 3, 2)).reshape(N, Lp, H)[:, :L]
    return o, lse


def dilated_window_attention(q, k, v):
    B = q.shape[0]
    outs, lses = [], []
    for window, dil in DIL_PATTERNS:
        o, lse = banded_window_attention(to_strided(q, dil), to_strided(k, dil), to_strided(v, dil), window // dil)
        outs.append(from_strided(o, dil, B))
        lses.append(from_strided(lse, dil, B))
    w = jax.nn.softmax(jnp.stack(lses, axis=0), axis=0)
    o = jnp.einsum('pbsh,pbshd->bshd', w, jnp.stack(outs, axis=0).astype(jnp.float32))
    return o.astype(q.dtype)


def even_mixer(x, cos, sin, w_in, conv_w, conv_b, ga_w, ga_b, gx_w, gx_b, rg_lam, w_out):
    B, S, _ = x.shape
    proj = x @ w_in
    a_gate, a_x, q, k, v = jnp.split(proj, [D_RNN, 2 * D_RNN, 2 * D_RNN + D_DIL, 2 * D_RNN + 2 * D_DIL], axis=-1)
    h = rg_lru(causal_depthwise_conv(a_x, conv_w, conv_b), ga_w, ga_b, gx_w, gx_b, rg_lam)
    ya = jax.nn.gelu(a_gate) * h
    q = apply_rope(q.reshape(B, S, H_DIL, HEAD_DIM), cos, sin)
    k = apply_rope(k.reshape(B, S, H_DIL, HEAD_DIM), cos, sin)
    v = v.reshape(B, S, H_DIL, HEAD_DIM)
    yb = dilated_window_attention(q, k, v).reshape(B, S, D_DIL)
    return jnp.concatenate([ya, yb], axis=-1) @ w_out


def causal_diff_attention(q, k, v, lam):
    B, S, H = q.shape[:3]
    nb = S // BLK
    qb = jnp.swapaxes(q.reshape(B, nb, BLK, H, 2, HEAD_DIM), 0, 1)
    kpos = jnp.arange(S)

    def one_block(args):
        qblk, start = args
        s = jnp.einsum('bqhmd,bkhmd->bmhqk', qblk, k).astype(jnp.float32) * (HEAD_DIM ** -0.5)
        qpos = start + jnp.arange(BLK)
        mask = kpos[None, :] <= qpos[:, None]
        p = jax.nn.softmax(jnp.where(mask, s, NEG), axis=-1)
        pd = p[:, 0] - lam * p[:, 1]
        return jnp.einsum('bhqk,bkhe->bqhe', pd.astype(v.dtype), v)

    o = lax.map(one_block, (qb, jnp.arange(nb) * BLK))
    return jnp.swapaxes(o, 0, 1).reshape(B, S, H, 2 * HEAD_DIM)


def odd_mixer(x, cos, sin, w_in, lq1, lk1, lq2, lk2, subln_g, w_out, lambda_init):
    B, S, _ = x.shape
    q, k, v = jnp.split(x @ w_in, 3, axis=-1)
    q = apply_rope(q.reshape(B, S, H_DIFF, 2, HEAD_DIM), cos, sin)
    k = apply_rope(k.reshape(B, S, H_DIFF, 2, HEAD_DIM), cos, sin)
    v = v.reshape(B, S, H_DIFF, 2 * HEAD_DIM)
    lam = (jnp.exp(jnp.sum(lq1.astype(jnp.float32) * lk1.astype(jnp.float32)))
           - jnp.exp(jnp.sum(lq2.astype(jnp.float32) * lk2.astype(jnp.float32))) + lambda_init)
    o = causal_diff_attention(q, k, v, lam).astype(jnp.float32)
    o = o * lax.rsqrt(jnp.mean(jnp.square(o), axis=-1, keepdims=True) + RMS_EPS) * subln_g.astype(jnp.float32)
    o = (o * (1.0 - lambda_init)).astype(x.dtype)
    return o.reshape(B, S, D_DIFF) @ w_out


def squared_relu_mlp(x, w1, w2):
    h = jax.nn.relu(x @ w1)
    return (h * h) @ w2


def setup_inputs(seed: int = 0) -> dict:
    key = jax.random.key(seed)
    ks = jax.random.split(key, 24)
    f32 = jnp.float32

    def nrm(k, shape, scale):
        return jax.random.normal(k, shape, f32) * scale

    u = jax.random.uniform(ks[9], (N_EVEN, D_RNN), f32, 0.9, 0.999)
    sg = u ** (1.0 / RG_C)
    rg_lambda = jnp.log(sg) - jnp.log1p(-sg)
    return {
        'x': nrm(ks[0], (BATCH, SEQ, D_MODEL), 1.0),
        'positions': jnp.broadcast_to(jnp.arange(SEQ, dtype=jnp.int32), (BATCH, SEQ)),
        'ev_w_in': nrm(ks[1], (N_EVEN, D_MODEL, EVEN_IN), D_MODEL ** -0.5),
        'ev_conv_w': nrm(ks[2], (N_EVEN, CONV_W, D_RNN), CONV_W ** -0.5),
        'ev_conv_b': nrm(ks[3], (N_EVEN, D_RNN), 0.01),
        'ev_gate_a_w': nrm(ks[4], (N_EVEN, RNN_BLOCKS, RNN_BLOCK_W, RNN_BLOCK_W), RNN_BLOCK_W ** -0.5),
        'ev_gate_a_b': nrm(ks[5], (N_EVEN, D_RNN), 0.01),
        'ev_gate_x_w': nrm(ks[6], (N_EVEN, RNN_BLOCKS, RNN_BLOCK_W, RNN_BLOCK_W), RNN_BLOCK_W ** -0.5),
        'ev_gate_x_b': nrm(ks[7], (N_EVEN, D_RNN), 0.01),
        'ev_rg_lambda': rg_lambda,
        'ev_w_out': nrm(ks[8], (N_EVEN, D_RNN + D_DIL, D_MODEL), (D_RNN + D_DIL) ** -0.5 * BETA),
        'od_w_in': nrm(ks[10], (N_ODD, D_MODEL, ODD_IN), D_MODEL ** -0.5),
        'od_lambda_q1': nrm(ks[11], (N_ODD, HEAD_DIM), 0.1),
        'od_lambda_k1': nrm(ks[12], (N_ODD, HEAD_DIM), 0.1),
        'od_lambda_q2': nrm(ks[13], (N_ODD, HEAD_DIM), 0.1),
        'od_lambda_k2': nrm(ks[14], (N_ODD, HEAD_DIM), 0.1),
        'od_subln_g': 1.0 + nrm(ks[15], (N_ODD, 2 * HEAD_DIM), 0.02),
        'od_w_out': nrm(ks[16], (N_ODD, D_DIFF, D_MODEL), D_DIFF ** -0.5 * BETA),
        'ln_mix_g': 1.0 + nrm(ks[17], (DEPTH, D_MODEL), 0.02),
        'ln_mix_b': nrm(ks[18], (DEPTH, D_MODEL), 0.01),
        'ln_mlp_g': 1.0 + nrm(ks[19], (DEPTH, D_MODEL), 0.02),
        'ln_mlp_b': nrm(ks[20], (DEPTH, D_MODEL), 0.01),
        'mlp_w1': nrm(ks[21], (DEPTH, D_MODEL, D_FF), D_MODEL ** -0.5),
        'mlp_w2': nrm(ks[22], (DEPTH, D_FF, D_MODEL), D_FF ** -0.5 * BETA),
    }


def reference(x, positions, ev_w_in, ev_conv_w, ev_conv_b, ev_gate_a_w, ev_gate_a_b, ev_gate_x_w,
              ev_gate_x_b, ev_rg_lambda, ev_w_out, od_w_in, od_lambda_q1, od_lambda_k1, od_lambda_q2,
              od_lambda_k2, od_subln_g, od_w_out, ln_mix_g, ln_mix_b, ln_mlp_g, ln_mlp_b, mlp_w1, mlp_w2):
    cos, sin = rope_tables(positions)
    for layer in range(DEPTH):
        p = layer // 2
        if layer % 2 == 0:
            mix = even_mixer(x, cos, sin, ev_w_in[p], ev_conv_w[p], ev_conv_b[p], ev_gate_a_w[p], ev_gate_a_b[p],
                             ev_gate_x_w[p], ev_gate_x_b[p], ev_rg_lambda[p], ev_w_out[p])
        else:
            lambda_init = 0.8 - 0.6 * math.exp(-0.3 * layer)
            mix = odd_mixer(x, cos, sin, od_w_in[p], od_lambda_q1[p], od_lambda_k1[p], od_lambda_q2[p],
                            od_lambda_k2[p], od_subln_g[p], od_w_out[p], lambda_init)
        x = layer_norm(ALPHA * x + mix, ln_mix_g[layer], ln_mix_b[layer])
        x = layer_norm(ALPHA * x + squared_relu_mlp(x, mlp_w1[layer], mlp_w2[layer]), ln_mlp_g[layer], ln_mlp_b[layer])
    return x
```

```cpp
#include <hip/hip_runtime.h>
#include <cstdio>
#include <cstdint>

namespace pg8 {
#define PG8_LAS __attribute__((address_space(3)))
#define PG8_GAS __attribute__((address_space(1)))
typedef unsigned short bf16_t;
typedef short bf16x8 __attribute__((ext_vector_type(8)));
typedef float f32x4 __attribute__((ext_vector_type(4)));
typedef unsigned u32x4 __attribute__((ext_vector_type(4)));
constexpr int BM = 256, BK = 64, HALF = 128, HTB = HALF * BK * 2, STAGE_BYTES = 8 * HTB, NXCD = 8, WGM = 8;

__host__ __device__ __forceinline__ int lds_byte(int r, int c) { const int st = (r >> 4) * 2 + (c >> 5), rr = r & 15, cc = c & 31, ob = rr * 64 + cc * 2; return st * 1024 + (ob ^ (((ob >> 9) & 1) << 5)); }
__host__ __device__ __forceinline__ void stage_rc(int b, int& R, int& C) { const int st = b / 1024, sb = b % 1024, swz = sb ^ (((sb >> 9) & 1) << 5); R = (st >> 1) * 16 + swz / 64; C = (st & 1) * 32 + (swz % 64) / 2; }
__host__ __device__ __forceinline__ int perm32(int rho) { const int n = rho >> 4, i = rho & 15; return 8 * (i >> 2) + 4 * n + (i & 3); }

struct Unit { int pm, pn; };
struct Gemm { const PG8_GAS bf16_t* A; const PG8_GAS bf16_t* Bt; int M, N, K; };

struct StaticOrder {
    int nM, nN, nwg, G, c;
    __host__ __device__ void init(int M, int N, int G_, int c_) { nM = M / BM; nN = N / BM; nwg = nM * nN; G = G_; c = c_; }
    __host__ __device__ bool next(int i, Unit& u) const {
        const long L = (long)i * G + c; if (L >= nwg) return false;
        int wgid = (int)L; { const int q = nwg / NXCD, r = nwg % NXCD, xcd = wgid % NXCD, off = wgid / NXCD; wgid = (xcd < r ? xcd * (q + 1) : r * (q + 1) + (xcd - r) * q) + off; }
        const int nig = WGM * nN, gid = wgid / nig, fm = gid * WGM, gsz = (nM - fm) < WGM ? (nM - fm) : WGM;
        u.pm = fm + ((wgid % nig) % gsz); u.pn = (wgid % nig) / gsz; return true;
    }
    __device__ __forceinline__ void a_ready(const Unit&) const {}
    __device__ __forceinline__ void done(const Unit&) const {}
};

__device__ __forceinline__ unsigned cvt_pk_bf16(float lo, float hi) { unsigned r; asm volatile("v_cvt_pk_bf16_f32 %0, %1, %2" : "=v"(r) : "v"(lo), "v"(hi)); return r; }

struct EpiProj {
    static constexpr bool PERM = true, AFTER_DRAIN = false;
    PG8_GAS bf16_t* O; int ldc; int rope_lo, rope_hi; const PG8_GAS float* cs;
    __device__ __forceinline__ void operator()(const f32x4 (&acc)[2][2][4][2], const Unit& u, int wr, int wc, int fr, int fq) const {
        const int row0 = u.pm * BM + wr * 64 + fr, colt = u.pn * BM, col0 = colt + wc * 32 + 8 * fq;
        const bool rope = (colt >= rope_lo) && (colt < rope_hi) && (wc == 0);
#pragma unroll
        for (int ai = 0; ai < 2; ++ai)
#pragma unroll
            for (int m = 0; m < 4; ++m) {
                const int row = row0 + ai * HALF + m * 16;
                f32x4 c4 = (f32x4){1.f, 1.f, 1.f, 1.f}, s4 = (f32x4){0.f, 0.f, 0.f, 0.f};
                if (rope) { c4 = *(const PG8_GAS f32x4*)(cs + (size_t)row * 32 + 4 * fq); s4 = *(const PG8_GAS f32x4*)(cs + (size_t)row * 32 + 16 + 4 * fq); }
                PG8_GAS bf16_t* rowp = O + (size_t)row * ldc + col0;
#pragma unroll
                for (int bj = 0; bj < 2; ++bj) {
                    const f32x4 v0 = acc[ai][bj][m][0], v1 = acc[ai][bj][m][1];
                    const float a0 = v0[0] * c4[0] - v0[1] * s4[0], a1 = v0[1] * c4[0] + v0[0] * s4[0];
                    const float a2 = v0[2] * c4[1] - v0[3] * s4[1], a3 = v0[3] * c4[1] + v0[2] * s4[1];
                    const float b0 = v1[0] * c4[2] - v1[1] * s4[2], b1 = v1[1] * c4[2] + v1[0] * s4[2];
                    const float b2 = v1[2] * c4[3] - v1[3] * s4[3], b3 = v1[3] * c4[3] + v1[2] * s4[3];
                    u32x4 w; w.x = cvt_pk_bf16(a0, a1); w.y = cvt_pk_bf16(a2, a3); w.z = cvt_pk_bf16(b0, b1); w.w = cvt_pk_bf16(b2, b3);
                    *(PG8_GAS u32x4*)(rowp + bj * HALF) = w; }
            }
    }
};
struct EpiRelu2 {
    static constexpr bool PERM = true, AFTER_DRAIN = false;
    PG8_GAS bf16_t* O; int ldc;
    __device__ __forceinline__ void operator()(const f32x4 (&acc)[2][2][4][2], const Unit& u, int wr, int wc, int fr, int fq) const {
        const int row0 = u.pm * BM + wr * 64 + fr, col0 = u.pn * BM + wc * 32 + 8 * fq;
#pragma unroll
        for (int ai = 0; ai < 2; ++ai)
#pragma unroll
            for (int m = 0; m < 4; ++m) { PG8_GAS bf16_t* rowp = O + (size_t)(row0 + ai * HALF + m * 16) * ldc + col0;
#pragma unroll
                for (int bj = 0; bj < 2; ++bj) { f32x4 v0 = acc[ai][bj][m][0], v1 = acc[ai][bj][m][1];
#pragma unroll
                    for (int e = 0; e < 4; ++e) { const float x = fmaxf(v0[e], 0.f), y = fmaxf(v1[e], 0.f); v0[e] = x * x; v1[e] = y * y; }
                    u32x4 w; w.x = cvt_pk_bf16(v0[0], v0[1]); w.y = cvt_pk_bf16(v0[2], v0[3]); w.z = cvt_pk_bf16(v1[0], v1[1]); w.w = cvt_pk_bf16(v1[2], v1[3]);
                    *(PG8_GAS u32x4*)(rowp + bj * HALF) = w; } }
    }
};
struct EpiResid {
    static constexpr bool PERM = false, AFTER_DRAIN = false;
    const PG8_GAS float* res; PG8_GAS float* out; int ldc; float alpha;
    __device__ __forceinline__ void operator()(const f32x4 (&acc)[2][2][4][2], const Unit& u, int wr, int wc, int fr, int fq) const {
        const int row0 = u.pm * BM + wr * 64 + fr, col0 = u.pn * BM + wc * 32 + 4 * fq;
#pragma unroll
        for (int ai = 0; ai < 2; ++ai)
#pragma unroll
            for (int m = 0; m < 4; ++m) { const size_t off = (size_t)(row0 + ai * HALF + m * 16) * ldc + col0;
#pragma unroll
                for (int bj = 0; bj < 2; ++bj)
#pragma unroll
                    for (int n = 0; n < 2; ++n) { const f32x4 r = *(const PG8_GAS f32x4*)(res + off + bj * HALF + n * 16);
                        *(PG8_GAS f32x4*)(out + off + bj * HALF + n * 16) = r * alpha + acc[ai][bj][m][n]; } }
    }
};

template <class Epi, class Sched, bool ALIGN_EPI = false, bool SP2 = false>
__device__ __forceinline__ void gemm_phase(PG8_LAS unsigned char* lds, const Gemm g, const Sched& S, const Epi& E) {
    int tid_ = threadIdx.x; asm volatile("" : "+v"(tid_));
    const int tid = tid_, wid = __builtin_amdgcn_readfirstlane(tid >> 6), lane = tid & 63, wr = wid >> 2, wc = wid & 3, fr = lane & 15, fq = lane >> 4;
    const int K = g.K, nt = K / BK;
    unsigned voffA[2], voffB[2];
#pragma unroll
    for (int i = 0; i < 2; ++i) { int R, C; stage_rc(tid * 16 + i * 8192, R, C); const int Rb = Epi::PERM ? ((R & ~31) + perm32(R & 31)) : R;
        voffA[i] = (unsigned)(R * K + C) * 2u; voffB[i] = (unsigned)(Rb * K + C) * 2u; }
    const size_t kstep = (size_t)(BK * 2);
    const size_t hstep = (size_t)HALF * K * 2;
    const size_t tstep = 2 * hstep;
    const unsigned ldsw = (unsigned)wid * 1024u;
    const int aoff = lds_byte(wr * 64 + fr, fq * 8), boff = lds_byte(wc * 32 + fr, fq * 8);
#define PG8_SA(b, h) (((b) * 2 + (h)) * HTB)
#define PG8_SB(b, h) ((4 + (b) * 2 + (h)) * HTB)
#define PG8_STAGE(bufoff, gbase, voff) do { _Pragma("unroll") for (int _i = 0; _i < 2; ++_i) \
        __builtin_amdgcn_global_load_lds((const PG8_GAS unsigned*)((const PG8_GAS char*)(gbase) + (voff)[_i]), (PG8_LAS unsigned*)(lds + (bufoff) + ldsw + _i * 8192), 16, 0, 0); } while (0)
#define PG8_LDA(dst, b, h) do { _Pragma("unroll") for (int m = 0; m < 4; ++m) _Pragma("unroll") for (int k = 0; k < 2; ++k) dst[m][k] = *(const PG8_LAS bf16x8*)(lds + PG8_SA(b, h) + aoff + m * 2048 + k * 1024); } while (0)
#define PG8_LDB(dst, b, h) do { _Pragma("unroll") for (int n = 0; n < 2; ++n) _Pragma("unroll") for (int k = 0; k < 2; ++k) dst[n][k] = *(const PG8_LAS bf16x8*)(lds + PG8_SB(b, h) + boff + n * 2048 + k * 1024); } while (0)
#define PG8_MMA(ai, bj, At, Bt) do { __builtin_amdgcn_s_setprio(1); _Pragma("unroll") for (int m = 0; m < 4; ++m) _Pragma("unroll") for (int n = 0; n < 2; ++n) _Pragma("unroll") for (int k = 0; k < 2; ++k) \
        acc[ai][bj][m][n] = __builtin_amdgcn_mfma_f32_16x16x32_bf16(Bt[n][k], At[m][k], acc[ai][bj][m][n], 0, 0, 0); __builtin_amdgcn_s_setprio(0); } while (0)
#define PG8_WAIT_V(n) asm volatile("s_waitcnt vmcnt(" #n ")" ::: "memory")
#define PG8_WAIT_L(n) asm volatile("s_waitcnt lgkmcnt(" #n ")" ::: "memory")
#define PG8_BAR __builtin_amdgcn_s_barrier()
#define PG8_SCHED __builtin_amdgcn_sched_barrier(0)
    Unit cur, nxt; int ui = 0;
    if (!S.next(0, cur)) return;
    f32x4 acc[2][2][4][2];
#pragma unroll
    for (int a = 0; a < 2; ++a)
#pragma unroll
        for (int b = 0; b < 2; ++b)
#pragma unroll
            for (int m = 0; m < 4; ++m)
#pragma unroll
                for (int n = 0; n < 2; ++n) acc[a][b][m][n] = (f32x4){0.f, 0.f, 0.f, 0.f};
    bf16x8 At[4][2], B0[2][2], B1[2][2];
    const PG8_GAS char* cA = (const PG8_GAS char*)g.A + (size_t)cur.pm * tstep; const PG8_GAS char* cB = (const PG8_GAS char*)g.Bt + (size_t)cur.pn * tstep;
    S.a_ready(cur);
    if constexpr (SP2) {
        PG8_STAGE(PG8_SB(0, 0), cB, voffB); PG8_STAGE(PG8_SB(0, 1), cB + hstep, voffB); PG8_STAGE(PG8_SA(0, 0), cA, voffA); PG8_STAGE(PG8_SA(0, 1), cA + hstep, voffA);
        if (wr == 1) PG8_BAR;
        PG8_WAIT_V(2); PG8_BAR;
        PG8_STAGE(PG8_SB(1, 0), cB + kstep, voffB); PG8_STAGE(PG8_SA(1, 0), cA + kstep, voffA); PG8_STAGE(PG8_SB(1, 1), cB + hstep + kstep, voffB);
        PG8_WAIT_V(6); PG8_BAR;
    } else {
        PG8_STAGE(PG8_SB(0, 0), cB, voffB); PG8_STAGE(PG8_SA(0, 0), cA, voffA); PG8_STAGE(PG8_SB(0, 1), cB + hstep, voffB); PG8_STAGE(PG8_SA(0, 1), cA + hstep, voffA);
        if (wr == 1) PG8_BAR;
        PG8_WAIT_V(4); PG8_BAR;
        PG8_STAGE(PG8_SB(1, 0), cB + kstep, voffB); PG8_STAGE(PG8_SA(1, 0), cA + kstep, voffA); PG8_STAGE(PG8_SB(1, 1), cB + hstep + kstep, voffB);
        PG8_WAIT_V(6); PG8_BAR;
    }
    for (;;) {
        const bool has_next = S.next(ui + 1, nxt);
        const PG8_GAS char* nA = has_next ? (const PG8_GAS char*)g.A + (size_t)nxt.pm * tstep : cA; const PG8_GAS char* nB = has_next ? (const PG8_GAS char*)g.Bt + (size_t)nxt.pn * tstep : cB;
        for (int t = 0; t < nt; t += 2) {
            const bool last = (t == nt - 2);
            const PG8_GAS char* a1 = cA + (size_t)(t + 1) * kstep;
            const PG8_GAS char* a2 = last ? nA : cA + (size_t)(t + 2) * kstep; const PG8_GAS char* b2 = last ? nB : cB + (size_t)(t + 2) * kstep;
            const PG8_GAS char* a3 = a2 + kstep; const PG8_GAS char* b3 = b2 + kstep;
            if (last && has_next) S.a_ready(nxt);
            if constexpr (SP2) {
            PG8_LDB(B0, 0, 0); PG8_LDB(B1, 0, 1); PG8_SCHED; PG8_LDA(At, 0, 0); PG8_STAGE(PG8_SA(1, 1), a1 + hstep, voffA);
            PG8_WAIT_V(8); PG8_WAIT_L(0); PG8_BAR; PG8_MMA(0, 0, At, B0); PG8_MMA(0, 1, At, B1); PG8_BAR; PG8_SCHED;
            PG8_LDA(At, 0, 1); PG8_STAGE(PG8_SB(0, 0), b2, voffB); PG8_STAGE(PG8_SB(0, 1), b2 + hstep, voffB); PG8_STAGE(PG8_SA(0, 0), a2, voffA);
            PG8_WAIT_V(8); PG8_WAIT_L(0); PG8_BAR; PG8_MMA(1, 0, At, B0); PG8_MMA(1, 1, At, B1); PG8_BAR; PG8_SCHED;
            PG8_LDB(B0, 1, 0); PG8_LDB(B1, 1, 1); PG8_SCHED; PG8_LDA(At, 1, 0); PG8_STAGE(PG8_SA(0, 1), a2 + hstep, voffA);
            PG8_WAIT_V(8); PG8_WAIT_L(0); PG8_BAR; PG8_MMA(0, 0, At, B0); PG8_MMA(0, 1, At, B1); PG8_BAR; PG8_SCHED;
            PG8_LDA(At, 1, 1); PG8_STAGE(PG8_SB(1, 0), b3, voffB); PG8_STAGE(PG8_SB(1, 1), b3 + hstep, voffB); PG8_STAGE(PG8_SA(1, 0), a3, voffA);
            PG8_WAIT_V(8); PG8_WAIT_L(0); PG8_BAR; PG8_MMA(1, 0, At, B0); PG8_MMA(1, 1, At, B1); PG8_BAR; PG8_SCHED;
            } else {
            PG8_LDB(B0, 0, 0); PG8_SCHED; PG8_LDA(At, 0, 0); PG8_STAGE(PG8_SA(1, 1), a1 + hstep, voffA);
            PG8_WAIT_L(8); PG8_BAR; PG8_WAIT_L(0); PG8_MMA(0, 0, At, B0); PG8_BAR; PG8_SCHED;
            PG8_LDB(B1, 0, 1); PG8_STAGE(PG8_SB(0, 0), b2, voffB);
            PG8_BAR; PG8_WAIT_L(0); PG8_MMA(0, 1, At, B1); PG8_BAR;
            PG8_LDA(At, 0, 1); PG8_STAGE(PG8_SA(0, 0), a2, voffA);
            PG8_BAR; PG8_WAIT_L(0); PG8_MMA(1, 0, At, B0); PG8_BAR; PG8_SCHED;
            PG8_STAGE(PG8_SB(0, 1), b2 + hstep, voffB);
            PG8_WAIT_V(6); PG8_BAR; PG8_MMA(1, 1, At, B1); PG8_BAR;
            PG8_LDB(B0, 1, 0); PG8_SCHED; PG8_LDA(At, 1, 0); PG8_STAGE(PG8_SA(0, 1), a2 + hstep, voffA);
            PG8_WAIT_L(8); PG8_BAR; PG8_WAIT_L(0); PG8_MMA(0, 0, At, B0); PG8_BAR; PG8_SCHED;
            PG8_LDB(B1, 1, 1); PG8_STAGE(PG8_SB(1, 0), b3, voffB);
            PG8_BAR; PG8_WAIT_L(0); PG8_MMA(0, 1, At, B1); PG8_BAR;
            PG8_LDA(At, 1, 1); PG8_STAGE(PG8_SA(1, 0), a3, voffA);
            PG8_BAR; PG8_WAIT_L(0); PG8_MMA(1, 0, At, B0); PG8_BAR; PG8_SCHED;
            PG8_STAGE(PG8_SB(1, 1), b3 + hstep, voffB);
            PG8_WAIT_V(6); PG8_BAR; PG8_MMA(1, 1, At, B1); PG8_BAR;
            }
        }
        if constexpr (ALIGN_EPI) { if (wr == 0) PG8_BAR; }
        if constexpr (!Epi::AFTER_DRAIN) { E(acc, cur, wr, wc, fr, fq); S.done(cur); }
        if (!has_next) break;
#pragma unroll
        for (int a = 0; a < 2; ++a)
#pragma unroll
            for (int b = 0; b < 2; ++b)
#pragma unroll
                for (int m = 0; m < 4; ++m)
#pragma unroll
                    for (int n = 0; n < 2; ++n) acc[a][b][m][n] = (f32x4){0.f, 0.f, 0.f, 0.f};
        cur = nxt; cA = nA; cB = nB; ++ui;
        if constexpr (ALIGN_EPI) { if (wr == 1) PG8_BAR; }
    }
    PG8_WAIT_V(0);
    if constexpr (!ALIGN_EPI) { if (wr == 0) PG8_BAR; }
    PG8_BAR;
#undef PG8_SA
#undef PG8_SB
#undef PG8_STAGE
#undef PG8_LDA
#undef PG8_LDB
#undef PG8_MMA
#undef PG8_WAIT_V
#undef PG8_WAIT_L
#undef PG8_BAR
#undef PG8_SCHED
}
}

namespace swa {
#define SWA_GAS __attribute__((address_space(1)))
typedef unsigned short bf16;
typedef short bf16x8 __attribute__((ext_vector_type(8)));
typedef short s16x4 __attribute__((ext_vector_type(4)));
typedef float f32x16 __attribute__((ext_vector_type(16)));
typedef float f32x4 __attribute__((ext_vector_type(4)));
typedef unsigned u32x4 __attribute__((ext_vector_type(4)));
constexpr int D = 128;
constexpr float SCALE = 0.08838834764831845f;
constexpr float THR = 8.f;
constexpr int NW = 8, QBLK = 32, KVBLK = 64, QB = NW * QBLK;
constexpr int SHM_V = KVBLK * D * 2, SHM_K = KVBLK * D * 2;
constexpr int LDS_BYTES = 2 * SHM_V + 2 * SHM_K + NW * 64 * 4;

#define KSWZ(row, colB) ((row) * 256 + ((colB) ^ (((row) & 7) << 4)))
#define SBAR() __builtin_amdgcn_sched_barrier(0)
__device__ __forceinline__ int v_st(int k, int c) { const int kk = (k & ~0xC) | ((k & 4) << 1) | ((k & 8) >> 1); return ((kk >> 3) * 4 + (c >> 5)) * 512 + ((kk & 7) * 32 + (c & 31)) * 2; }
__device__ __forceinline__ int v_rd_base(int lane) { return ((lane & 3) << 3) | (((lane >> 2) & 3) << 6) | (((lane >> 4) & 1) << 5) | (((lane >> 5) & 1) << 8); }
constexpr int v_rd_off(int d0, int ks, int half) { return d0 * 512 + ks * 4096 + half * 2048; }
__device__ __forceinline__ int crow(int r, int hi) { return (r & 3) + 8 * (r >> 2) + 4 * hi; }
__device__ __forceinline__ unsigned cvtpk(float lo, float hi) { unsigned r; asm volatile("v_cvt_pk_bf16_f32 %0, %1, %2" : "=v"(r) : "v"(lo), "v"(hi)); return r; }
__device__ __forceinline__ bf16x8 ld8(const SWA_GAS bf16* p) { return *(const SWA_GAS bf16x8*)p; }

__device__ __forceinline__ void mask_tile(f32x16& p0, f32x16& p1, int dq, unsigned W) {
    const float NEG = -__builtin_inff();
#pragma unroll
    for (int r = 0; r < 16; ++r) {
        const int c = (r & 3) + 8 * (r >> 2);
        if ((unsigned)(dq - c) >= W) p0[r] = NEG;
        if ((unsigned)(dq - c - 32) >= W) p1[r] = NEG;
    }
}
__device__ __forceinline__ void partialSM(f32x16& p0, f32x16& p1, float& m_reg, float& mn, float& alpha) {
    float pmax = p0[0]; for (int r = 1; r < 16; ++r) pmax = fmaxf(pmax, p0[r]); for (int r = 0; r < 16; ++r) pmax = fmaxf(pmax, p1[r]);
    { auto rr = __builtin_amdgcn_permlane32_swap(__float_as_uint(pmax), __float_as_uint(pmax), false, false);
      pmax = fmaxf(__uint_as_float(rr[0]), __uint_as_float(rr[1])); }
    constexpr float C2 = 1.4426950408889634f * SCALE;
    if (__builtin_expect(__all((pmax - m_reg) * SCALE <= THR), 1)) { mn = m_reg; alpha = 1.f; }
    else { mn = fmaxf(m_reg, pmax); alpha = __builtin_amdgcn_exp2f((m_reg - mn) * C2); m_reg = mn; }
    const float mnL = -mn * C2;
    for (int r = 0; r < 16; ++r) p0[r] = fmaf(p0[r], C2, mnL); for (int r = 0; r < 16; ++r) p1[r] = fmaf(p1[r], C2, mnL);
    for (int r = 0; r < 16; ++r) p0[r] = __builtin_amdgcn_exp2f(p0[r]);
}
__device__ __forceinline__ void finishSM(f32x16& p0, f32x16& p1, float alpha, float& l_reg, bf16x8& pa0, bf16x8& pa1, bf16x8& pa2, bf16x8& pa3) {
    for (int r = 0; r < 16; ++r) p1[r] = __builtin_amdgcn_exp2f(p1[r]);
    float ps = 0; for (int r = 0; r < 16; ++r) ps += p0[r]; for (int r = 0; r < 16; ++r) ps += p1[r];
    { auto rr = __builtin_amdgcn_permlane32_swap(__float_as_uint(ps), __float_as_uint(ps), false, false);
      ps = __uint_as_float(rr[0]) + __uint_as_float(rr[1]); }
    l_reg = l_reg * alpha + ps;
#define PK4(P, B_, OUT) do { unsigned a0 = cvtpk(P[B_+0], P[B_+1]), a1 = cvtpk(P[B_+2], P[B_+3]);                          \
        unsigned b0 = cvtpk(P[B_+4], P[B_+5]), b1 = cvtpk(P[B_+6], P[B_+7]);                                             \
        auto r0 = __builtin_amdgcn_permlane32_swap(a0, b0, false, false); auto r1 = __builtin_amdgcn_permlane32_swap(a1, b1, false, false); \
        u32x4 w = {r0[0], r1[0], r0[1], r1[1]}; OUT = *reinterpret_cast<bf16x8*>(&w); } while (0)
    PK4(p0, 0, pa0); PK4(p0, 8, pa1); PK4(p1, 0, pa2); PK4(p1, 8, pa3);
#undef PK4
}
template <int KB, bool SK>
__device__ __forceinline__ void qkt(f32x16& p0, f32x16& p1, const char* K_lds, int r32, int hi, const bf16x8* qr, bool act) {
    if (SK && !act) { const float NEG = -__builtin_inff();
#pragma unroll
        for (int r = 0; r < 16; ++r) { p0[r] = NEG; p1[r] = NEG; } return; }
    p0 = f32x16{}; p1 = f32x16{};
    const char* kb[4];
#pragma unroll
    for (int dd = 0; dd < 4; ++dd) kb[dd] = K_lds + KB * SHM_K + KSWZ(r32, (dd * 16 + hi * 8) * 2);
#pragma unroll
    for (int d0 = 0; d0 < 8; ++d0) { const char* a = kb[d0 & 3] + (d0 >> 2) * 128;
        bf16x8 b0 = *reinterpret_cast<const bf16x8*>(a);
        bf16x8 b1 = *reinterpret_cast<const bf16x8*>(a + 32 * 256);
        p0 = __builtin_amdgcn_mfma_f32_32x32x16_bf16(b0, qr[d0], p0, 0, 0, 0);
        p1 = __builtin_amdgcn_mfma_f32_32x32x16_bf16(b1, qr[d0], p1, 0, 0, 0); }
}
template <int VB, bool SK>
__device__ __forceinline__ void pv_tile(f32x16* o, int vb0, bf16x8 pa0, bf16x8 pa1, bf16x8 pa2, bf16x8 pa3, bool act) {
    if (SK && !act) return;
#define TRRD(dst, off) asm volatile("ds_read_b64_tr_b16 %0, %1 offset:%2" : "=&v"(dst) : "v"(vb0), "i"(off) : "memory")
#define PV_D0(d0) do { s16x4 l0, l1, l2, l3, h0, h1, h2, h3; constexpr int b_ = VB * SHM_V + v_rd_off(d0, 0, 0); \
        TRRD(l0, b_); TRRD(h0, b_ + 2048); TRRD(l1, b_ + 4096); TRRD(h1, b_ + 6144); TRRD(l2, b_ + 8192); TRRD(h2, b_ + 10240); TRRD(l3, b_ + 12288); TRRD(h3, b_ + 14336); \
        asm volatile("s_waitcnt lgkmcnt(0)" ::: "memory"); SBAR();   \
        o[d0] = __builtin_amdgcn_mfma_f32_32x32x16_bf16(pa0, (bf16x8){l0[0], l0[1], l0[2], l0[3], h0[0], h0[1], h0[2], h0[3]}, o[d0], 0, 0, 0);   \
        o[d0] = __builtin_amdgcn_mfma_f32_32x32x16_bf16(pa1, (bf16x8){l1[0], l1[1], l1[2], l1[3], h1[0], h1[1], h1[2], h1[3]}, o[d0], 0, 0, 0);   \
        o[d0] = __builtin_amdgcn_mfma_f32_32x32x16_bf16(pa2, (bf16x8){l2[0], l2[1], l2[2], l2[3], h2[0], h2[1], h2[2], h2[3]}, o[d0], 0, 0, 0);   \
        o[d0] = __builtin_amdgcn_mfma_f32_32x32x16_bf16(pa3, (bf16x8){l3[0], l3[1], l3[2], l3[3], h3[0], h3[1], h3[2], h3[3]}, o[d0], 0, 0, 0); } while (0)
    PV_D0(0); PV_D0(1); PV_D0(2); PV_D0(3);
#undef PV_D0
#undef TRRD
}

struct BlockRef { const SWA_GAS bf16* Q; const SWA_GAS bf16* K; const SWA_GAS bf16* V; SWA_GAS bf16* O; SWA_GAS float* L; int P0, skv, pin, po, pl; };
struct Seam { bf16x8 qr[8]; bf16x8 st_v0, st_v1, st_k0, st_k1; };
__device__ __forceinline__ int swa_jlo(int P0, int W) { const int lowk = P0 - W + 1; return lowk > 0 ? lowk / KVBLK : 0; }
#define ROW(p, pitch, k0, rr) ((p) + (size_t)((k0) + (rr)) * (size_t)(pitch) + sc)
#define VMW() asm volatile("s_waitcnt vmcnt(0)" ::: "memory")
#define VMWN(n) asm volatile("s_waitcnt vmcnt(%0)" :: "i"(n) : "memory")
#define SLOAD_H(Kp, Vp, pitch, k0) do { S.st_v0 = ld8(ROW(Vp, pitch, k0, sr)); S.st_v1 = ld8(ROW(Vp, pitch, k0, 32 + sr));              \
                         S.st_k0 = ld8(ROW(Kp, pitch, k0, sr)); S.st_k1 = ld8(ROW(Kp, pitch, k0, 32 + sr)); } while (0)
#define SWRITE_HK(bf) do { *(bf16x8*)(K_lds + (bf) * SHM_K + kws) = S.st_k0; *(bf16x8*)(K_lds + (bf) * SHM_K + kws + 32 * 256) = S.st_k1; } while (0)
#define SWRITE_HV(bf) do { *(bf16x8*)(V_lds + (bf) * SHM_V + vst0) = S.st_v0; *(bf16x8*)(V_lds + (bf) * SHM_V + vst1) = S.st_v1; } while (0)
#define SWRITE_H(bf) do { SWRITE_HV(bf); SWRITE_HK(bf); } while (0)
__device__ __forceinline__ void swa_prime(const BlockRef& cur, int W, char* lds, Seam& S) {
    int tid_ = threadIdx.x; asm volatile("" : "+v"(tid_));
    const int tid = tid_, wid = __builtin_amdgcn_readfirstlane(tid >> 6), lane = tid & 63, r32 = lane & 31, hi = lane >> 5;
    const int sr = tid >> 4, sc = (tid & 15) * 8, kws = KSWZ(sr, sc * 2); char* K_lds = lds + 2 * SHM_V;
    const int kb0 = swa_jlo(cur.P0, W) * KVBLK;
    for (int d0 = 0; d0 < 8; ++d0) S.qr[d0] = ld8(cur.Q + (size_t)(wid * QBLK + r32) * (size_t)cur.pin + d0 * 16 + hi * 8);
    SLOAD_H(cur.K, cur.V, cur.pin, kb0); VMW(); SWRITE_HK(0);
    __syncthreads();
}
template <bool SK>
__device__ __forceinline__ void swa_block(const BlockRef& cur, const BlockRef& nxt, int W, char* lds, Seam& S) {
    int tid_ = threadIdx.x; asm volatile("" : "+v"(tid_));
    const int tid = tid_, wid = __builtin_amdgcn_readfirstlane(tid >> 6), lane = tid & 63, r32 = lane & 31, hi = lane >> 5;
    const int j_lo = swa_jlo(cur.P0, W);
    int j_hi = (cur.P0 + QB - 1) / KVBLK + 1; if (j_hi > cur.skv / KVBLK) j_hi = cur.skv / KVBLK;
    const int NT = j_hi - j_lo;
    const int kbn = swa_jlo(nxt.P0, W) * KVBLK;
    const int qlo = cur.P0 + wid * QBLK, qm = qlo + r32 - 4 * hi;
    char* V_lds = lds; char* K_lds = lds + 2 * SHM_V;
    float* ws = (float*)(lds + 2 * SHM_V + 2 * SHM_K) + wid * 64; float* li_l = ws, * al_l = ws + 32;
    float m_reg = -1e30f, l_reg = 0; f32x16 o[4] = {};
    const int sr = tid >> 4, sc = (tid & 15) * 8, vst0 = v_st(sr, sc), vst1 = v_st(32 + sr, sc), kws = KSWZ(sr, sc * 2);
    const int vb0 = (int)(uintptr_t)V_lds + v_rd_base(lane);
    const SWA_GAS bf16* Kh = cur.K; const SWA_GAS bf16* Vh = cur.V; const int pin = cur.pin;
#define RESC(a) do { if (__any((a) < 1.f)) { if (hi == 0) al_l[r32] = (a); asm volatile("s_waitcnt lgkmcnt(0)" ::: "memory");              \
                     for (int d_ = 0; d_ < 4; ++d_) for (int r = 0; r < 16; ++r) o[d_][r] *= al_l[crow(r, hi)]; } } while (0)
#define KBASE(t) ((j_lo + (t)) * KVBLK)
#define ACT(t) (KBASE(t) <= qlo + QBLK - 1 && KBASE(t) + KVBLK - 1 >= qlo - W + 1)
#define MASKT(P0_, P1_, t) do { const int kb_ = KBASE(t); if ((!SK || ACT(t)) && (kb_ + KVBLK - 1 > qlo || kb_ <= qlo + QBLK - 1 - W)) mask_tile(P0_, P1_, qm - kb_, (unsigned)W); } while (0)
#define SEAM_K0() do { VMWN(8); SWRITE_HK(0); SBAR(); } while (0)
    f32x16 pA0, pA1, pB0, pB1; float mnA, mnB, alA, alB; bf16x8 pa0, pa1, pa2, pa3;
    SWRITE_HV(0); SBAR();
    if (NT > 1) { SLOAD_H(Kh, Vh, pin, KBASE(1)); }
    SBAR(); qkt<0, SK>(pA0, pA1, K_lds, r32, hi, S.qr, ACT(0));
    MASKT(pA0, pA1, 0); partialSM(pA0, pA1, m_reg, mnA, alA);
    if (NT > 1) { VMW(); SWRITE_H(1); }
    __syncthreads();
#define HALF_STEP(PX0, PX1, mnX, alX, PY0, PY1, alY, t, KB, VB, SB) do {                                                      \
        SBAR(); qkt<KB, SK>(PX0, PX1, K_lds, r32, hi, S.qr, ACT(t));                                             \
        finishSM(PY0, PY1, alY, l_reg, pa0, pa1, pa2, pa3); SBAR();                                                           \
        if ((t) + 1 < NT) { SLOAD_H(Kh, Vh, pin, KBASE((t) + 1)); SBAR(); }                                               \
        pv_tile<VB, SK>(o, vb0, pa0, pa1, pa2, pa3, ACT((t) - 1)); MASKT(PX0, PX1, (t)); partialSM(PX0, PX1, m_reg, mnX, alX);                                        \
        __syncthreads();                                                                                                      \
        if ((t) + 1 < NT) { VMW(); SWRITE_H(SB); }                                                                          \
        RESC(alX); __syncthreads(); } while (0)
    for (int t = 1; t + 1 < NT; t += 2) {
        HALF_STEP(pB0, pB1, mnB, alB, pA0, pA1, alA, t, 1, 0, 0);
        HALF_STEP(pA0, pA1, mnA, alA, pB0, pB1, alB, t + 1, 0, 1, 1);
    }
    const bool even = (NT & 1) == 0;
    if (even) { SBAR(); qkt<1, SK>(pB0, pB1, K_lds, r32, hi, S.qr, ACT(NT - 1)); SBAR(); }
    SLOAD_H(nxt.K, nxt.V, nxt.pin, kbn); SBAR();
#pragma unroll
    for (int d0 = 0; d0 < 8; ++d0) S.qr[d0] = ld8(nxt.Q + (size_t)(wid * QBLK + r32) * (size_t)nxt.pin + d0 * 16 + hi * 8);
    SBAR();
    finishSM(pA0, pA1, alA, l_reg, pa0, pa1, pa2, pa3); SBAR();
    pv_tile<0, SK>(o, vb0, pa0, pa1, pa2, pa3, ACT(even ? NT - 2 : NT - 1));
    if (even) { MASKT(pB0, pB1, NT - 1); partialSM(pB0, pB1, m_reg, mnB, alB); __syncthreads(); RESC(alB);
        finishSM(pB0, pB1, alB, l_reg, pa0, pa1, pa2, pa3); SBAR(); pv_tile<1, SK>(o, vb0, pa0, pa1, pa2, pa3, ACT(NT - 1)); }
    SBAR(); SEAM_K0();
    if (hi == 0) li_l[r32] = l_reg; asm volatile("s_waitcnt lgkmcnt(0)" ::: "memory");
    if (cur.pl != 0 && hi == 0) cur.L[(size_t)(wid * QBLK + r32) * (size_t)cur.pl] = m_reg * SCALE + 0.6931471805599453f * __builtin_amdgcn_logf(l_reg);
    float rli[16];
#pragma unroll
    for (int r = 0; r < 16; ++r) rli[r] = __builtin_amdgcn_rcpf(li_l[crow(r, hi)]);
    SWA_GAS bf16* Ow = cur.O + (size_t)(wid * QBLK) * (size_t)cur.po;
#pragma unroll
    for (int r = 0; r < 16; ++r) { const int orow = crow(r, hi);
#pragma unroll
        for (int d0 = 0; d0 < 4; ++d0) { const float v = o[d0][r] * rli[r];
            const float vn = __uint_as_float((unsigned)__builtin_amdgcn_update_dpp(0, (int)__float_as_uint(v), 0xB1, 0xf, 0xf, true));
            if ((r32 & 1) == 0) *(SWA_GAS unsigned*)(Ow + (size_t)orow * (size_t)cur.po + d0 * 32 + r32) = cvtpk(v, vn); } }
    __syncthreads();
#undef RESC
#undef KBASE
#undef ACT
#undef MASKT
#undef SEAM_K0
#undef HALF_STEP
}
#undef ROW
#undef VMW
#undef VMWN
#undef SLOAD_H
#undef SWRITE_HK
#undef SWRITE_HV
#undef SWRITE_H
}

constexpr int SEQ = 16384, DM = 2048, DFF = 8192, DEPTH = 4;
constexpr int D_RNN = 1024, EVEN_IN = 5120, ODD_IN = 6144;
constexpr float ALPHA = 1.681792830507429f;
constexpr float LN_EPS = 1e-5f, RMS_EPS = 1e-5f;
constexpr int NWAVES = 8, NTHREADS = 512;

constexpr size_t MiB = 1u << 20;
constexpr size_t WS_CTL = 0, CTL_ZERO_BYTES = 1 * MiB;
constexpr size_t WS_PAR = 1 * MiB;
constexpr size_t WS_ROPE = 2 * MiB;
constexpr size_t WS_GW = 4 * MiB;
constexpr size_t WS_AGG = 5 * MiB;
constexpr size_t WS_LSE = 6 * MiB;
constexpr size_t WS_W = 8 * MiB;
constexpr size_t W_LAYER = 96 * MiB, W_OUT = 24 * MiB, W_1 = 32 * MiB, W_2 = 64 * MiB;
constexpr size_t WS_X = WS_W + 4 * W_LAYER;
constexpr size_t WS_XN = WS_X + 128 * MiB;
constexpr size_t WS_A = WS_XN + 64 * MiB;
constexpr size_t WS_MIX = WS_A + 192 * MiB;
constexpr size_t WS_B = WS_A + 256 * MiB;
constexpr size_t WS_END = WS_B + 128 * MiB;
constexpr int CW_BAR = 4096;

constexpr int RING_BYTES = 131072;
constexpr int LDSCTL_OFF = RING_BYTES, MISC_OFF = LDSCTL_OFF + 320;
constexpr int LDS_BYTES = 147456;

#define GAS __attribute__((address_space(1)))
#define LAS __attribute__((address_space(3)))
typedef unsigned short bf16;
typedef unsigned v4u __attribute__((ext_vector_type(4)));
typedef unsigned v2u __attribute__((ext_vector_type(2)));
typedef float f32x4 __attribute__((ext_vector_type(4)));
typedef short bf16x8 __attribute__((ext_vector_type(8)));
#define LDS_WAIT() asm volatile("s_waitcnt lgkmcnt(0)" ::: "memory")
#define VM_WAIT() asm volatile("s_waitcnt vmcnt(0)" ::: "memory")
__device__ __forceinline__ unsigned f2bf(float f) { unsigned u = __builtin_bit_cast(unsigned, f); return (u + 0x7fffu + ((u >> 16) & 1u)) >> 16; }
__device__ __forceinline__ unsigned pk2(float lo, float hi) { return f2bf(lo) | (f2bf(hi) << 16); }
__device__ __forceinline__ float bf2f(unsigned b) { return __uint_as_float(b << 16); }
__device__ __forceinline__ float bflo(unsigned w) { return __uint_as_float(w << 16); }
__device__ __forceinline__ float bfhi(unsigned w) { return __uint_as_float(w & 0xffff0000u); }

#define XB_TMO      128
#define XB_XCNT(j)  (256  + 64 * (j))
#define XB_XSUB(j)  (1280 + 64 * (j))
#define XB_XGEN(j)  (2304 + 64 * (j))
#define XB_TOP      3328
#define XB_TOPGEN   3392
#define XCD_BAR_WORDS 3456
#define XB_SPIN_CAP (1u << 18)
__device__ __forceinline__ unsigned xb_ld(unsigned* p)              { return __hip_atomic_load(p, __ATOMIC_RELAXED, __HIP_MEMORY_SCOPE_AGENT); }
__device__ __forceinline__ unsigned xb_add(unsigned* p, unsigned v) { return __hip_atomic_fetch_add(p, v, __ATOMIC_RELAXED, __HIP_MEMORY_SCOPE_AGENT); }
__device__ __forceinline__ unsigned xb_xcc_id() { return (unsigned)__builtin_amdgcn_s_getreg((3 << 11) | 20) & 0xFu; }
#define XB_SPIN(cond, bar) do { unsigned _sp = 0; while (cond) { __builtin_amdgcn_s_sleep(1); \
    if ((++_sp & 255u) == 0u) { if (xb_ld(&(bar)[XB_TMO])) break; if (_sp > XB_SPIN_CAP) { atomicAdd(&(bar)[XB_TMO], 1u); break; } } } } while (0)
struct XcdBarrier { unsigned* bar; unsigned x; volatile LAS unsigned* st; };
__device__ __forceinline__ XcdBarrier xcd_barrier_post(unsigned* bar, volatile LAS unsigned* st) {
    XcdBarrier b; b.bar = bar; b.x = xb_xcc_id(); b.st = st;
    if (threadIdx.x == 0) (void)xb_add(&bar[XB_XCNT(b.x)], 1u);
    return b;
}
__device__ __forceinline__ void xcd_barrier_complete(unsigned* bar, unsigned x, unsigned& nloc, unsigned& nx) {
    const unsigned G = gridDim.x * gridDim.y * gridDim.z;
    unsigned sum, cnt, mine, sp = 0u;
    for (;;) {
        sum = 0u; cnt = 0u; mine = 0u;
#pragma unroll
        for (unsigned j = 0; j < 16; ++j) { const unsigned c = xb_ld(&bar[XB_XCNT(j)]); sum += c; cnt += (c > 0u) ? 1u : 0u; mine = (j == x) ? c : mine; }
        if (sum == G) break;
        __builtin_amdgcn_s_sleep(1);
        if ((++sp & 255u) == 0u) { if (xb_ld(&bar[XB_TMO])) break; if (sp > XB_SPIN_CAP) { atomicAdd(&bar[XB_TMO], 1u); break; } }
    }
    nloc = mine > 0u ? mine : 1u; nx = cnt > 0u ? cnt : 1u;
}
__device__ __forceinline__ void xcd_barrier(const XcdBarrier& b) {
    asm volatile("s_waitcnt vmcnt(0)" ::: "memory");
    __syncthreads();
    if (threadIdx.x == 0) {
        unsigned* bar = b.bar; unsigned bx_ = b.x;
        asm volatile("" : "+s"(bar), "+s"(bx_));
        __builtin_amdgcn_s_waitcnt(0);
        unsigned nloc = b.st[0], nx = b.st[1];
        if (nloc == 0u) { xcd_barrier_complete(bar, bx_, nloc, nx); b.st[0] = nloc; b.st[1] = nx; }
        const unsigned old = xb_add(&bar[XB_XSUB(bx_)], 1u);
        const unsigned gen = old / nloc;
        if (old + 1u == (gen + 1u) * nloc) {
            __builtin_amdgcn_fence(__ATOMIC_RELEASE, "agent");
            asm volatile("s_waitcnt vmcnt(0)" ::: "memory");
            const unsigned og = xb_add(&bar[XB_TOP], 1u);
            const unsigned tg = og / nx;
            if (og + 1u == (tg + 1u) * nx) xb_add(&bar[XB_TOPGEN], 1u);
            else XB_SPIN(xb_ld(&bar[XB_TOPGEN]) == tg, bar);
            __builtin_amdgcn_fence(__ATOMIC_ACQUIRE, "agent");
            xb_add(&bar[XB_XGEN(bx_)], 1u);
            asm volatile("s_waitcnt vmcnt(0)" ::: "memory");
        } else {
            XB_SPIN(xb_ld(&bar[XB_XGEN(bx_)]) == gen, bar);
            __builtin_amdgcn_fence(__ATOMIC_ACQUIRE, "agent");
            asm volatile("s_waitcnt vmcnt(0)" ::: "memory");
        }
    }
    __syncthreads();
}

typedef const GAS float* gcf;
typedef GAS float* gf;
typedef const GAS bf16* gcb;
typedef GAS bf16* gb;
struct KArgs { const void* in[24]; float* out; unsigned char* ws; };
struct Frame { LAS unsigned char* lds; int vcu, G; };
#define PHASE_IDS() int tid_ = threadIdx.x; asm volatile("" : "+v"(tid_)); const int tid = tid_, lane = tid & 63, wave = __builtin_amdgcn_readfirstlane(tid >> 6); (void)lane; (void)wave
__device__ __forceinline__ float shfl_xor_l(float v, int m, int lane) { return __uint_as_float((unsigned)__builtin_amdgcn_ds_bpermute((lane ^ m) << 2, (int)__float_as_uint(v))); }
__device__ __forceinline__ float wave_sum_l(float v, int lane) {
#pragma unroll
    for (int o = 1; o < 64; o <<= 1) v += shfl_xor_l(v, o, lane);
    return v;
}

__device__ __forceinline__ void p0_transpose_item(gcf W, int K, int N, gb WT, int rope_lo, int rope_hi, LAS float* scr, int item, int lane) {
    const int nblk = N / 32, kb = item / nblk, nb = item % nblk, k0 = 64 * kb, n0 = 32 * nb;
    const bool pair32 = (n0 >= rope_lo) && (n0 < rope_hi) && ((n0 & 127) == 0);
    const int j = lane & 31, src = pair32 ? ((j >> 1) + ((j & 1) << 4)) : j;
#pragma unroll 8
    for (int i = 0; i < 32; ++i) { const int kk = 2 * i + (lane >> 5); scr[kk * 33 + j] = W[(size_t)(k0 + kk) * N + n0 + src]; }
    LDS_WAIT(); asm volatile("" ::: "memory");
    const int c = lane & 7;
#pragma unroll
    for (int jj = 0; jj < 4; ++jj) { const int n = (lane >> 3) + 8 * jj; const LAS float* sp = scr + (8 * c) * 33 + n;
        v4u o; o.x = pk2(sp[0 * 33], sp[1 * 33]); o.y = pk2(sp[2 * 33], sp[3 * 33]); o.z = pk2(sp[4 * 33], sp[5 * 33]); o.w = pk2(sp[6 * 33], sp[7 * 33]);
        *(GAS v4u*)(WT + (size_t)(n0 + n) * K + k0 + 8 * c) = o; }
    LDS_WAIT(); asm volatile("" ::: "memory");
}
__device__ __forceinline__ void prologue(const Frame& F, const KArgs& a, GAS unsigned char* ws) {
    PHASE_IDS();
    LAS float* scr = (LAS float*)(F.lds + wave * 16384);
    const int gw = F.vcu * NWAVES + wave, NGW = F.G * NWAVES;
    for (int mi = 0; mi < 16; ++mi) {
        gcf src; gb dst; int K, N, rlo = 0, rhi = 0;
        if (mi < 2)       { const int p = mi;      src = (gcf)a.in[2]  + (size_t)p * DM * EVEN_IN; K = DM; N = EVEN_IN; dst = (gb)(ws + WS_W + (size_t)(2 * p) * W_LAYER); rlo = 2048; rhi = 4096; }
        else if (mi < 4)  { const int p = mi - 2;  src = (gcf)a.in[10] + (size_t)p * DM * DM;      K = DM; N = DM;      dst = (gb)(ws + WS_W + (size_t)(2 * p) * W_LAYER + W_OUT); }
        else if (mi < 6)  { const int p = mi - 4;  src = (gcf)a.in[11] + (size_t)p * DM * ODD_IN;  K = DM; N = ODD_IN;  dst = (gb)(ws + WS_W + (size_t)(2 * p + 1) * W_LAYER); rlo = 0; rhi = 4096; }
        else if (mi < 8)  { const int p = mi - 6;  src = (gcf)a.in[17] + (size_t)p * DM * DM;      K = DM; N = DM;      dst = (gb)(ws + WS_W + (size_t)(2 * p + 1) * W_LAYER + W_OUT); }
        else if (mi < 12) { const int l = mi - 8;  src = (gcf)a.in[22] + (size_t)l * DM * DFF;     K = DM; N = DFF;     dst = (gb)(ws + WS_W + (size_t)l * W_LAYER + W_1); }
        else              { const int l = mi - 12; src = (gcf)a.in[23] + (size_t)l * DFF * DM;     K = DFF; N = DM;     dst = (gb)(ws + WS_W + (size_t)l * W_LAYER + W_2); }
        const int nitems = (K / 64) * (N / 32);
        for (int it = gw; it < nitems; it += NGW) p0_transpose_item(src, K, N, dst, rlo, rhi, scr, it, lane);
    }
    {
        gcf x = (gcf)a.in[0]; gb xn = (gb)(ws + WS_XN);
        for (int m = gw; m < SEQ; m += NGW) {
            const GAS f32x4* xr = (const GAS f32x4*)(x + (size_t)m * DM) + lane;
            GAS v2u* o8 = (GAS v2u*)(xn + (size_t)m * DM) + lane;
#pragma unroll
            for (int j = 0; j < 8; ++j) { const f32x4 v = xr[64 * j]; v2u w; w.x = pk2(v.x, v.y); w.y = pk2(v.z, v.w); o8[64 * j] = w; }
        }
    }
    const int gt = F.vcu * NTHREADS + tid, NGT = F.G * NTHREADS;
    {
        const GAS int* pos = (const GAS int*)a.in[1]; gf cs = (gf)(ws + WS_ROPE);
        for (int e = gt; e < SEQ * 16; e += NGT) { const int t = e >> 4, i = e & 15;
            const float inv = (float)pow(500000.0, -(double)i / 16.0);
            const float ang = (float)pos[t] * inv;
            cs[(size_t)t * 32 + i] = (float)cos((double)ang); cs[(size_t)t * 32 + 16 + i] = (float)sin((double)ang); }
    }
    {
        gcf ga = (gcf)a.in[5]; gcf gx = (gcf)a.in[7]; gb gwT = (gb)(ws + WS_GW);
        for (int e = gt; e < 2 * 2 * 16 * 64 * 64; e += NGT) { const int c = e & 63, d = (e >> 6) & 63, n = (e >> 12) & 15, g = (e >> 16) & 1, p = e >> 17;
            gcf w = g ? gx : ga; gwT[e] = (bf16)f2bf(w[(((size_t)p * 16 + n) * 64 + c) * 64 + d]); }
    }
    {
        gcf lam = (gcf)a.in[9]; gf par = (gf)(ws + WS_PAR);
        for (int e = gt; e < 2 * 1024; e += NGT) { const float x = -lam[e]; const float sp = (x > 20.f) ? x : log1pf(expf(x)); par[1024 + e] = 8.0f * sp; }
        if (gt < 2) { const int p = gt; gcf q1 = (gcf)a.in[12] + p * 128; gcf k1 = (gcf)a.in[13] + p * 128; gcf q2 = (gcf)a.in[14] + p * 128; gcf k2 = (gcf)a.in[15] + p * 128;
            float s1 = 0.f, s2 = 0.f; for (int i = 0; i < 128; ++i) { s1 += q1[i] * k1[i]; s2 += q2[i] * k2[i]; }
            const float lambda_init = 0.8f - 0.6f * expf(-0.3f * (float)(2 * p + 1));
            par[p] = expf(s1) - expf(s2) + lambda_init; }
    }
}

__device__ __forceinline__ void ln_phase(const Frame& F, gcf y, gf xo, gb xn, gcf g, gcf b) {
    PHASE_IDS();
    const int gw = F.vcu * NWAVES + wave, NGW = F.G * NWAVES;
    for (int m = gw; m < SEQ; m += NGW) {
        const GAS f32x4* yr = (const GAS f32x4*)(y + (size_t)m * DM) + lane;
        f32x4 v[8]; float s = 0.f;
#pragma unroll
        for (int j = 0; j < 8; ++j) { v[j] = yr[64 * j]; s += (v[j].x + v[j].y) + (v[j].z + v[j].w); }
        const float mean = wave_sum_l(s, lane) * (1.f / DM); float s2 = 0.f;
#pragma unroll
        for (int j = 0; j < 8; ++j) { v[j] = v[j] - mean; s2 += (v[j].x * v[j].x + v[j].y * v[j].y) + (v[j].z * v[j].z + v[j].w * v[j].w); }
        const float rstd = 1.f / sqrtf(wave_sum_l(s2, lane) * (1.f / DM) + LN_EPS);
        GAS f32x4* xr = (GAS f32x4*)(xo + (size_t)m * DM) + lane;
        GAS v2u* o8 = (GAS v2u*)(xn + (size_t)m * DM) + lane;
        const GAS f32x4* gr = (const GAS f32x4*)g + lane; const GAS f32x4* br = (const GAS f32x4*)b + lane;
#pragma unroll
        for (int j = 0; j < 8; ++j) { const f32x4 o = v[j] * rstd * gr[64 * j] + br[64 * j]; xr[64 * j] = o; v2u w; w.x = pk2(o.x, o.y); w.y = pk2(o.z, o.w); o8[64 * j] = w; }
    }
}

__device__ __forceinline__ void odd_combine(const Frame& F, gcb O, gb mix, gcf subln_g, float lam, float one_minus_li) {
    PHASE_IDS();
    const int gw = F.vcu * NWAVES + wave, NGW = F.G * NWAVES;
    const f32x4 g4 = *((const GAS f32x4*)subln_g + lane);
    for (int m = gw; m < SEQ; m += NGW) {
        const GAS v2u* orow = (const GAS v2u*)(O + (size_t)m * 4096);
        GAS v2u* mrow = (GAS v2u*)(mix + (size_t)m * DM);
        v2u w0[8], w1[8];
#pragma unroll
        for (int h = 0; h < 8; ++h) { w0[h] = orow[(2 * h) * 64 + lane]; w1[h] = orow[(2 * h + 1) * 64 + lane]; }
#pragma unroll
        for (int h = 0; h < 8; ++h) {
            f32x4 o; o.x = bflo(w0[h].x) - lam * bflo(w1[h].x); o.y = bfhi(w0[h].x) - lam * bfhi(w1[h].x); o.z = bflo(w0[h].y) - lam * bflo(w1[h].y); o.w = bfhi(w0[h].y) - lam * bfhi(w1[h].y);
            const float ss = wave_sum_l((o.x * o.x + o.y * o.y) + (o.z * o.z + o.w * o.w), lane);
            const float sc = one_minus_li / sqrtf(ss * (1.f / 256.f) + RMS_EPS);
            v2u w; w.x = pk2(o.x * sc * g4.x, o.y * sc * g4.y); w.y = pk2(o.z * sc * g4.z, o.w * sc * g4.w);
            mrow[h * 64 + lane] = w;
        }
    }
}

__device__ __forceinline__ void even_combine(const Frame& F, gcb Od, gcf lse, gb mix) {
    PHASE_IDS();
    const int gw = F.vcu * NWAVES + wave, NGW = F.G * NWAVES;
    const int h = lane >> 3;
    for (int m = gw; m < SEQ; m += NGW) {
        const float l0 = lse[((size_t)0 * SEQ + m) * 8 + h], l1 = lse[((size_t)1 * SEQ + m) * 8 + h], l2 = lse[((size_t)2 * SEQ + m) * 8 + h];
        const float mx = fmaxf(l0, fmaxf(l1, l2));
        float e0 = __expf(l0 - mx), e1 = __expf(l1 - mx), e2 = __expf(l2 - mx);
        const float inv = 1.f / (e0 + e1 + e2); e0 *= inv; e1 *= inv; e2 *= inv;
        v4u a[2], b[2], c[2];
#pragma unroll
        for (int q = 0; q < 2; ++q) {
            a[q] = *((const GAS v4u*)(Od + ((size_t)0 * SEQ + m) * 1024) + lane * 2 + q);
            b[q] = *((const GAS v4u*)(Od + ((size_t)1 * SEQ + m) * 1024) + lane * 2 + q);
            c[q] = *((const GAS v4u*)(Od + ((size_t)2 * SEQ + m) * 1024) + lane * 2 + q);
        }
#pragma unroll
        for (int q = 0; q < 2; ++q) {
            v4u o;
#define CMB(f) o.f = pk2(e0 * bflo(a[q].f) + e1 * bflo(b[q].f) + e2 * bflo(c[q].f), e0 * bfhi(a[q].f) + e1 * bfhi(b[q].f) + e2 * bfhi(c[q].f))
            CMB(x); CMB(y); CMB(z); CMB(w);
#undef CMB
            *((GAS v4u*)(mix + (size_t)m * DM + 1024) + lane * 2 + q) = o;
        }
    }
}

constexpr int RG_TC = 128, RG_NCH = SEQ / RG_TC;
__device__ __forceinline__ float gelu_tanh(float x) { const float u = 0.7978845608028654f * (x + 0.044715f * x * x * x); return 0.5f * x * (1.f + tanhf(u)); }
__device__ __forceinline__ float sigmoidf_(float x) { return 1.f / (1.f + __expf(-x)); }
template <bool PASS2>
__device__ __forceinline__ void rglru_unit(const Frame& F, const KArgs& a, GAS unsigned char* ws, int p, int tc, int n) {
    PHASE_IDS();
    gcb proj = (gcb)(ws + WS_A); gb mix = (gb)(ws + WS_MIX);
    LAS unsigned short* XC = (LAS unsigned short*)(F.lds);
    LAS float* XF = (LAS float*)(F.lds + 18432);
    LAS float* AA = (LAS float*)(F.lds + 18432 + 32768);
    LAS float* SEG = (LAS float*)(F.lds + 18432 + 65536);
    LAS float* CAR = (LAS float*)(F.lds + 18432 + 65536 + 4096);
    const int c = tid & 63, tq = tid >> 6, ch = n * 64 + c, t0 = tc * RG_TC, ts = t0 + tq * 16;
    gcf conv_w = (gcf)a.in[3] + (size_t)p * 4 * D_RNN; gcf conv_b = (gcf)a.in[4] + (size_t)p * D_RNN;
    {
        const float w0 = conv_w[0 * D_RNN + ch], w1 = conv_w[1 * D_RNN + ch], w2 = conv_w[2 * D_RNN + ch], w3 = conv_w[3 * D_RNN + ch], cb = conv_b[ch];
        float xv[19];
#pragma unroll
        for (int i = 0; i < 19; ++i) { const int t = ts - 3 + i; xv[i] = (t >= 0) ? bf2f((unsigned)proj[(size_t)t * EVEN_IN + 1024 + ch]) : 0.f; }
#pragma unroll
        for (int i = 0; i < 16; ++i) { const float xc = cb + w0 * xv[i] + w1 * xv[i + 1] + w2 * xv[i + 2] + w3 * xv[i + 3];
            const int tl = tq * 16 + i; XF[tl * 64 + c] = xc; XC[tl * 72 + c] = (unsigned short)f2bf(xc); }
    }
    unsigned gatev[8];
    if (PASS2) {
#pragma unroll
        for (int i = 0; i < 8; ++i) { const unsigned g0 = proj[(size_t)(ts + 2 * i) * EVEN_IN + ch], g1 = proj[(size_t)(ts + 2 * i + 1) * EVEN_IN + ch]; gatev[i] = g0 | (g1 << 16); }
    }
    __syncthreads();
    {
        const int fr = lane & 15, fq = lane >> 4, w = wave;
        gcb gwT = (gcb)(ws + WS_GW);
        gcf ga_b = (gcf)a.in[6] + (size_t)p * D_RNN; gcf gx_b = (gcf)a.in[8] + (size_t)p * D_RNN;
        gcf sp8 = (gcf)(ws + WS_PAR) + 1024 + p * 1024;
        bf16x8 af[2];
#pragma unroll
        for (int ks = 0; ks < 2; ++ks) af[ks] = *(const LAS bf16x8*)(XC + (16 * w + fr) * 72 + 32 * ks + 8 * fq);
#pragma unroll
        for (int cb = 0; cb < 4; ++cb) {
            f32x4 ra = (f32x4){0.f, 0.f, 0.f, 0.f}, ri = (f32x4){0.f, 0.f, 0.f, 0.f};
#pragma unroll
            for (int ks = 0; ks < 2; ++ks) {
                const bf16x8 ba = *(const GAS bf16x8*)(gwT + ((((size_t)p * 2 + 0) * 16 + n) * 64 + 16 * cb + fr) * 64 + 32 * ks + 8 * fq);
                const bf16x8 bx = *(const GAS bf16x8*)(gwT + ((((size_t)p * 2 + 1) * 16 + n) * 64 + 16 * cb + fr) * 64 + 32 * ks + 8 * fq);
                ra = __builtin_amdgcn_mfma_f32_16x16x32_bf16(ba, af[ks], ra, 0, 0, 0);
                ri = __builtin_amdgcn_mfma_f32_16x16x32_bf16(bx, af[ks], ri, 0, 0, 0);
            }
            const int d0 = 16 * cb + 4 * fq, t = 16 * w + fr;
            const f32x4 bav = *(const GAS f32x4*)(ga_b + n * 64 + d0), bxv = *(const GAS f32x4*)(gx_b + n * 64 + d0), spv = *(const GAS f32x4*)(sp8 + n * 64 + d0);
            const f32x4 xcv = *(const LAS f32x4*)(XF + t * 64 + d0);
            f32x4 av, uv;
#pragma unroll
            for (int r = 0; r < 4; ++r) {
                const float rr = sigmoidf_(ra[r] + bav[r]), ii = sigmoidf_(ri[r] + bxv[r]);
                const float log_a = -rr * spv[r];
                av[r] = expf(log_a);
                uv[r] = sqrtf(-expm1f(2.f * log_a)) * (ii * xcv[r]);
            }
            *(LAS f32x4*)(AA + t * 64 + d0) = av; *(LAS f32x4*)(XF + t * 64 + d0) = uv;
        }
    }
    __syncthreads();
    {
        float P = 1.f, h = 0.f;
#pragma unroll
        for (int i = 0; i < 16; ++i) { const float av = AA[(tq * 16 + i) * 64 + c], uv = XF[(tq * 16 + i) * 64 + c]; h = av * h + uv; P *= av; }
        SEG[(tq * 64 + c) * 2] = P; SEG[(tq * 64 + c) * 2 + 1] = h;
        if (PASS2) {
            gcf agg = (gcf)(ws + WS_AGG);
            float Pc = 1.f, Hc = 0.f;
            for (int k = tq * 16; k < tq * 16 + 16 && k < tc; ++k) { const float pk = agg[((size_t)k * D_RNN + ch) * 2], hk = agg[((size_t)k * D_RNN + ch) * 2 + 1]; Hc = pk * Hc + hk; Pc *= pk; }
            CAR[(tq * 64 + c) * 2] = Pc; CAR[(tq * 64 + c) * 2 + 1] = Hc;
        }
    }
    __syncthreads();
    if (!PASS2) {
        if (tq == 7) { float Pt = 1.f, Ht = 0.f;
#pragma unroll
            for (int s = 0; s < 8; ++s) { const float ps = SEG[(s * 64 + c) * 2], hs = SEG[(s * 64 + c) * 2 + 1]; Ht = ps * Ht + hs; Pt *= ps; }
            gf agg = (gf)(ws + WS_AGG); agg[((size_t)tc * D_RNN + ch) * 2] = Pt; agg[((size_t)tc * D_RNN + ch) * 2 + 1] = Ht; }
    } else {
        float h = 0.f;
#pragma unroll
        for (int s = 0; s < 8; ++s) { h = CAR[(s * 64 + c) * 2] * h + CAR[(s * 64 + c) * 2 + 1]; }
        for (int s = 0; s < tq; ++s) { h = SEG[(s * 64 + c) * 2] * h + SEG[(s * 64 + c) * 2 + 1]; }
#pragma unroll
        for (int i = 0; i < 16; ++i) { const float av = AA[(tq * 16 + i) * 64 + c], uv = XF[(tq * 16 + i) * 64 + c]; h = av * h + uv;
            const unsigned gw_ = gatev[i >> 1]; const float gate = (i & 1) ? bfhi(gw_) : bflo(gw_);
            mix[(size_t)(ts + i) * DM + ch] = (bf16)f2bf(gelu_tanh(gate) * h); }
    }
    __syncthreads();
}

__device__ __forceinline__ swa::BlockRef dil_block(int idx, gcb proj, gb Od, gf lse) {
    const int pt = idx >> 9, r = idx & 511, h = r >> 6, s = r & 63;
    const int d = (pt == 0) ? 1 : (pt == 1 ? 4 : 16);
    const int rho = s % d, jb = s / d;
    const size_t row0 = (size_t)rho + (size_t)d * jb * 256;
    swa::BlockRef b;
    b.Q = proj + row0 * EVEN_IN + 2048 + h * 128; b.K = proj + (size_t)rho * EVEN_IN + 3072 + h * 128; b.V = proj + (size_t)rho * EVEN_IN + 4096 + h * 128;
    b.O = Od + ((size_t)pt * SEQ + row0) * 1024 + h * 128; b.L = lse + ((size_t)pt * SEQ + row0) * 8 + h;
    b.P0 = jb * 256; b.skv = SEQ / d; b.pin = d * EVEN_IN; b.po = d * 1024; b.pl = d * 8;
    return b;
}
__device__ __forceinline__ swa::BlockRef diff_block(int bi, gcb proj, gb O, gf dummy) {
    const int L = bi >> 1, pass = bi & 1, h = L & 7, k = L >> 3, combo = k >> 5, y = k & 31, m = combo >> 1, vh = combo & 1;
    const int qb = pass ? (63 - y) : y;
    swa::BlockRef b;
    b.Q = proj + (size_t)qb * 256 * ODD_IN + h * 256 + m * 128; b.K = proj + 2048 + h * 256 + m * 128; b.V = proj + 4096 + h * 256 + vh * 128;
    b.O = O + (size_t)qb * 256 * 4096 + (h * 2 + m) * 256 + vh * 128; b.L = dummy;
    b.P0 = qb * 256; b.skv = SEQ; b.pin = ODD_IN; b.po = 4096; b.pl = 0;
    return b;
}

#ifndef EN_GEMM
#define EN_GEMM 1
#endif
#ifndef EN_G1
#define EN_G1 1
#endif
#ifndef EN_G2
#define EN_G2 1
#endif
#ifndef EN_G3
#define EN_G3 1
#endif
#ifndef EN_G4
#define EN_G4 1
#endif
#ifndef EN_DIL
#define EN_DIL 1
#endif
#ifndef EN_DIFF
#define EN_DIFF 1
#endif
#ifndef EN_RG
#define EN_RG 1
#endif
#ifndef EN_THIN
#define EN_THIN 1
#endif
#ifndef EN_PRO
#define EN_PRO 1
#endif
__global__ void __launch_bounds__(NTHREADS, 2) trunk_fwd(KArgs args) {
    extern __shared__ __attribute__((aligned(16))) unsigned char lds[];
    Frame F;
    F.lds = (LAS unsigned char*)lds;
    F.G = gridDim.x; { const int bx = blockIdx.x; F.vcu = (F.G % 8 == 0) ? (bx % 8) * (F.G / 8) + bx / 8 : bx; }
    for (int u = threadIdx.x; u < (LDS_BYTES - LDSCTL_OFF) / 4; u += NTHREADS) ((LAS unsigned*)(F.lds + LDSCTL_OFF))[u] = 0u;
    __syncthreads();
    volatile LAS unsigned* MISC = (volatile LAS unsigned*)(F.lds + MISC_OFF);
    XcdBarrier bar = xcd_barrier_post((unsigned*)(args.ws + WS_CTL) + CW_BAR, MISC + 8);
#define WSP(name) GAS unsigned char* name = (GAS unsigned char*)args.ws; asm volatile("" : "+s"(name))

    if (EN_PRO) { WSP(ws); prologue(F, args, ws); }
    xcd_barrier(bar);

    for (int layer = 0; layer < DEPTH; ++layer) {
        const int p = layer >> 1; const bool even = (layer & 1) == 0;
        if (EN_GEMM && EN_G1) {
            WSP(ws); const int N = even ? EVEN_IN : ODD_IN;
            pg8::Gemm g{(gcb)(ws + WS_XN), (gcb)(ws + WS_W + (size_t)layer * W_LAYER), SEQ, N, DM}; pg8::StaticOrder S; S.init(SEQ, N, F.G, (int)blockIdx.x);
            pg8::EpiProj E{(gb)(ws + WS_A), N, even ? 2048 : 0, 4096, (gcf)(ws + WS_ROPE)};
            pg8::gemm_phase<pg8::EpiProj, pg8::StaticOrder, true, true>(F.lds, g, S, E);
        }
        xcd_barrier(bar);
        if (even) {
            if (EN_RG) { WSP(ws); for (int u = F.vcu; u < RG_NCH * 16; u += F.G) rglru_unit<false>(F, args, ws, p, u >> 4, u & 15); }
            if (EN_DIL) {
                WSP(ws); gcb PROJ = (gcb)(ws + WS_A); gb OB = (gb)(ws + WS_B); gf LSE = (gf)(ws + WS_LSE);
                const int nblk = 1536; int idx = blockIdx.x;
                if (idx < nblk) {
                    swa::Seam S; swa::BlockRef cur = dil_block(idx, PROJ, OB, LSE);
                    swa::swa_prime(cur, 129, (char*)lds, S);
                    for (;;) { const int nidx = idx + F.G; const bool last = nidx >= nblk;
                        const swa::BlockRef nxt = last ? cur : dil_block(nidx, PROJ, OB, LSE);
                        swa::swa_block<true>(cur, nxt, 129, (char*)lds, S);
                        if (last) break; cur = nxt; idx = nidx; }
                }
                VM_WAIT(); __syncthreads();
            }
            xcd_barrier(bar);
            if (EN_RG) { WSP(ws); for (int u = F.vcu; u < RG_NCH * 16; u += F.G) rglru_unit<true>(F, args, ws, p, u >> 4, u & 15); }
            if (EN_THIN) { WSP(ws); even_combine(F, (gcb)(ws + WS_B), (gcf)(ws + WS_LSE), (gb)(ws + WS_MIX)); }
        } else {
            if (EN_DIFF) {
                WSP(ws); gcb PROJ = (gcb)(ws + WS_A); gb OB = (gb)(ws + WS_B); gf LSE = (gf)(ws + WS_LSE);
                const int nitem = 1024; int L = blockIdx.x;
                if (L < nitem) {
                    int bi = 2 * L;
                    swa::Seam S; swa::BlockRef cur = diff_block(bi, PROJ, OB, LSE);
                    swa::swa_prime(cur, SEQ, (char*)lds, S);
                    for (;;) { int nbi = (bi & 1) ? 2 * (L + F.G) : bi + 1; const bool last = nbi >= 2 * nitem;
                        const swa::BlockRef nxt = last ? cur : diff_block(nbi, PROJ, OB, LSE);
                        swa::swa_block<false>(cur, nxt, SEQ, (char*)lds, S);
                        if (last) break; cur = nxt; if (bi & 1) L += F.G; bi = nbi; }
                }
                VM_WAIT(); __syncthreads();
            }
            xcd_barrier(bar);
            if (EN_THIN) { WSP(ws); const float lambda_init = 0.8f - 0.6f * expf(-0.3f * (float)layer);
                odd_combine(F, (gcb)(ws + WS_B), (gb)(ws + WS_MIX), (gcf)args.in[16] + p * 256, ((gcf)(ws + WS_PAR))[p], 1.f - lambda_init); }
        }
        xcd_barrier(bar);
        if (EN_GEMM && EN_G2) {
            WSP(ws); gf X = (gf)(ws + WS_X);
            pg8::Gemm g{(gcb)(ws + WS_MIX), (gcb)(ws + WS_W + (size_t)layer * W_LAYER + W_OUT), SEQ, DM, DM}; pg8::StaticOrder S; S.init(SEQ, DM, F.G, (int)blockIdx.x);
            pg8::EpiResid E{layer == 0 ? (gcf)args.in[0] : (gcf)X, X, DM, ALPHA};
            pg8::gemm_phase<pg8::EpiResid, pg8::StaticOrder, true, true>(F.lds, g, S, E);
        }
        xcd_barrier(bar);
        if (EN_THIN) { WSP(ws); gf X = (gf)(ws + WS_X); ln_phase(F, X, X, (gb)(ws + WS_XN), (gcf)args.in[18] + layer * DM, (gcf)args.in[19] + layer * DM); }
        xcd_barrier(bar);
        if (EN_GEMM && EN_G3) {
            WSP(ws);
            pg8::Gemm g{(gcb)(ws + WS_XN), (gcb)(ws + WS_W + (size_t)layer * W_LAYER + W_1), SEQ, DFF, DM}; pg8::StaticOrder S; S.init(SEQ, DFF, F.G, (int)blockIdx.x);
            pg8::EpiRelu2 E{(gb)(ws + WS_A), DFF};
            pg8::gemm_phase<pg8::EpiRelu2, pg8::StaticOrder, true, true>(F.lds, g, S, E);
        }
        xcd_barrier(bar);
        if (EN_GEMM && EN_G4) {
            WSP(ws); gf X = (gf)(ws + WS_X);
            pg8::Gemm g{(gcb)(ws + WS_A), (gcb)(ws + WS_W + (size_t)layer * W_LAYER + W_2), SEQ, DM, DFF}; pg8::StaticOrder S; S.init(SEQ, DM, F.G, (int)blockIdx.x);
            pg8::EpiResid E{X, X, DM, ALPHA};
            pg8::gemm_phase<pg8::EpiResid, pg8::StaticOrder, true, true>(F.lds, g, S, E);
        }
        xcd_barrier(bar);
        if (EN_THIN) { WSP(ws); gf X = (gf)(ws + WS_X); ln_phase(F, X, (layer == DEPTH - 1) ? (gf)args.out : X, (gb)(ws + WS_XN), (gcf)args.in[20] + layer * DM, (gcf)args.in[21] + layer * DM); }
        if (layer != DEPTH - 1) xcd_barrier(bar);
    }
#undef WSP
}

extern "C" void kernel_launch(void* const* d_in, const int* in_sizes, int n_in, void* d_out, int out_size, void* d_ws, size_t ws_size, hipStream_t stream) {
    static int grid = 0;
    if (grid == 0) {
        if (n_in != 24 || in_sizes[0] != SEQ * DM || out_size != SEQ * DM || ws_size < WS_END) {
            fprintf(stderr, "kernel_launch: unexpected shapes (n_in %d, in0 %d, out %d, ws %zu, need %zu); nothing launched\n", n_in, n_in > 0 ? in_sizes[0] : -1, out_size, ws_size, (size_t)WS_END); grid = -1; return; }
        int dev = 0, cus = 0, per_cu = 0;
        if (hipGetDevice(&dev) != hipSuccess || hipDeviceGetAttribute(&cus, hipDeviceAttributeMultiprocessorCount, dev) != hipSuccess) { grid = -1; return; }
        if (hipFuncSetAttribute((const void*)trunk_fwd, hipFuncAttributeMaxDynamicSharedMemorySize, LDS_BYTES) != hipSuccess) { fprintf(stderr, "kernel_launch: hipFuncSetAttribute failed\n"); grid = -1; return; }
        if (hipOccupancyMaxActiveBlocksPerMultiprocessor(&per_cu, (const void*)trunk_fwd, NTHREADS, LDS_BYTES) != hipSuccess || per_cu < 1) {
            fprintf(stderr, "kernel_launch: occupancy query reports %d workgroups per CU\n", per_cu); }
        (void)hipGetLastError();
        grid = cus;
    }
    if (grid < 0) return;
    if (hipMemsetAsync((char*)d_ws + WS_CTL, 0, CTL_ZERO_BYTES, stream) != hipSuccess) return;
    KArgs a{};
    for (int i = 0; i < 24; ++i) a.in[i] = d_in[i];
    a.out = (float*)d_out; a.ws = (unsigned char*)d_ws;
    hipLaunchKernelGGL(trunk_fwd, dim3(grid), dim3(NTHREADS), LDS_BYTES, stream, a);
}
```
